# Optimizing an MI355X kernel written in HIP

```python
import jax, jax.numpy as jnp
from jax import lax
import numpy as np

D_MODEL = 1024
BATCH = 16
SEQ = 2048
DEPTH = 1

POOL_WIDTH = D_MODEL // 2
POOL_WINDOWS = (2, 4, 8, 16)
N_POOL_GROUPS = len(POOL_WINDOWS)
POOL_GROUP = POOL_WIDTH // N_POOL_GROUPS
N_HEADS = 8
HEAD_DIM = 64
ATTN_WIDTH = N_HEADS * HEAD_DIM
MOBA_BLOCK = 256
MOBA_TOPK = 3
Q_CHUNK = 32
D_FF = 4 * D_MODEL
N_BRANCHES = 2
IN_WIDTH = POOL_WIDTH + 3 * ATTN_WIDTH + N_BRANCHES * D_MODEL
EPS = 1e-6
NEG = -1e30

kernel_name = "hybrid_pool_moba_gated_block"


def rmsnorm(x, g):
    xf = x.astype(jnp.float32)
    y = xf * lax.rsqrt(jnp.mean(xf * xf, axis=-1, keepdims=True) + EPS) * g.astype(jnp.float32)
    return y.astype(x.dtype)


def alibi_slopes(n_heads):
    return jnp.asarray(2.0 ** (-8.0 * np.arange(1, n_heads + 1) / n_heads), dtype=jnp.float32)


def pool_mixer(p, pool_w, pool_scale):
    pf = p.astype(jnp.float32)
    B, S, _ = pf.shape
    cs = jnp.concatenate([jnp.zeros_like(pf[:, :1]), jnp.cumsum(pf, axis=1)], axis=1)
    t = jnp.arange(S)
    outs = []
    for g, w in enumerate(POOL_WINDOWS):
        sl = slice(g * POOL_GROUP, (g + 1) * POOL_GROUP)
        lo = jnp.maximum(t + 1 - w, 0)
        win_sum = cs[:, 1:, sl] - cs[:, lo, sl]
        count = jnp.minimum(t + 1, w).astype(jnp.float32)[None, :, None]
        outs.append(win_sum / count - pf[:, :, sl])
    y = jnp.stack(outs, axis=2)
    y = jnp.einsum('bsgc,gcd->bsgd', y, pool_w.astype(jnp.float32))
    y = y.reshape(B, S, POOL_WIDTH) * pool_scale.astype(jnp.float32)
    return y.astype(p.dtype)


def moba_attention(q, k, v):
    B, S, H, Dh = q.shape
    nb = -(-S // MOBA_BLOCK)
    s_pad = nb * MOBA_BLOCK
    qf = q.transpose(0, 2, 1, 3).astype(jnp.float32) * (HEAD_DIM ** -0.5)
    pad = ((0, 0), (0, 0), (0, s_pad - S), (0, 0))
    kf = jnp.pad(k.transpose(0, 2, 1, 3).astype(jnp.float32), pad)
    vf = jnp.pad(v.transpose(0, 2, 1, 3).astype(jnp.float32), pad)
    kb = kf.reshape(B, H, nb, MOBA_BLOCK, Dh)
    vb = vf.reshape(B, H, nb, MOBA_BLOCK, Dh)
    slope = alibi_slopes(H)[None, :, None, None]
    t = jnp.arange(S)
    qblk = t // MOBA_BLOCK
    k_sel = min(MOBA_TOPK, nb - 1)
    if k_sel > 0:
        kmean = jnp.mean(kb, axis=3)
        gate = jnp.einsum('bhsd,bhnd->bhsn', qf, kmean)
        past = jnp.arange(nb)[None, :] < qblk[:, None]
        gate = jnp.where(past[None, None], gate, NEG)
        _, sel = lax.top_k(gate, k_sel)
    else:
        sel = jnp.zeros((B, H, S, 0), dtype=jnp.int32)
    n_chunks = S // Q_CHUNK
    q_c = qf.reshape(B, H, n_chunks, Q_CHUNK, Dh).transpose(2, 0, 1, 3, 4)
    sel_c = sel.reshape(B, H, n_chunks, Q_CHUNK, k_sel).transpose(2, 0, 1, 3, 4)
    bi = jnp.arange(B)[:, None, None]
    hi = jnp.arange(H)[None, :, None]
    kpos_in = jnp.arange(MOBA_BLOCK)

    def chunk_attn(args):
        c, qc, selc = args
        tq = c * Q_CHUNK + jnp.arange(Q_CHUNK)
        own = (c * Q_CHUNK) // MOBA_BLOCK
        k_own = lax.dynamic_slice_in_dim(kf, own * MOBA_BLOCK, MOBA_BLOCK, axis=2)
        v_own = lax.dynamic_slice_in_dim(vf, own * MOBA_BLOCK, MOBA_BLOCK, axis=2)
        ks = own * MOBA_BLOCK + kpos_in
        dist = (tq[:, None] - ks[None, :]).astype(jnp.float32)
        s_own = jnp.einsum('bhqd,bhkd->bhqk', qc, k_own) - slope * dist[None, None]
        s_own = jnp.where((ks[None, :] <= tq[:, None])[None, None], s_own, NEG)
        scores = [s_own]
        idxs = []
        for j in range(k_sel):
            idx = selc[..., j]
            kg = kb[bi, hi, idx]
            kpos = idx[..., None] * MOBA_BLOCK + kpos_in
            d = (tq[None, None, :, None] - kpos).astype(jnp.float32)
            s = jnp.einsum('bhqd,bhqkd->bhqk', qc, kg) - slope * d
            s = jnp.where((idx < own)[..., None], s, NEG)
            scores.append(s)
            idxs.append(idx)
        p = jax.nn.softmax(jnp.concatenate(scores, axis=-1), axis=-1)
        out = jnp.einsum('bhqk,bhkd->bhqd', p[..., :MOBA_BLOCK], v_own)
        for j, idx in enumerate(idxs):
            vg = vb[bi, hi, idx]
            pj = p[..., (j + 1) * MOBA_BLOCK:(j + 2) * MOBA_BLOCK]
            out = out + jnp.einsum('bhqk,bhqkd->bhqd', pj, vg)
        return out

    out = lax.map(chunk_attn, (jnp.arange(n_chunks), q_c, sel_c))
    out = out.transpose(1, 0, 3, 2, 4).reshape(B, S, H * Dh)
    return out.astype(q.dtype)


def setup_inputs(seed: int = 0) -> dict:
    key = jax.random.key(seed)
    ks = jax.random.split(key, 16)
    f32 = jnp.float32

    def nrm(k, shape, fan_in):
        return jax.random.normal(k, shape, f32) * (fan_in ** -0.5)

    def gain(k, shape):
        return 1.0 + 0.02 * jax.random.normal(k, shape, f32)

    L = DEPTH
    return {
        "x": jax.random.normal(ks[0], (BATCH, SEQ, D_MODEL), f32),
        "norm_mix_pre": gain(ks[1], (L, D_MODEL)),
        "w_in": nrm(ks[2], (L, D_MODEL, IN_WIDTH), D_MODEL),
        "b_gate": 0.01 * jax.random.normal(ks[3], (L, N_BRANCHES * D_MODEL), f32),
        "pool_w": nrm(ks[4], (L, N_POOL_GROUPS, POOL_GROUP, POOL_GROUP), POOL_GROUP),
        "pool_scale": gain(ks[5], (L, POOL_WIDTH)),
        "w_branch_pool": nrm(ks[6], (L, POOL_WIDTH, D_MODEL), POOL_WIDTH),
        "w_branch_attn": nrm(ks[7], (L, ATTN_WIDTH, D_MODEL), ATTN_WIDTH),
        "w_out": nrm(ks[8], (L, D_MODEL, D_MODEL), D_MODEL),
        "norm_mix_post": gain(ks[9], (L, D_MODEL)),
        "norm_mlp_pre": gain(ks[10], (L, D_MODEL)),
        "w_up": nrm(ks[11], (L, D_MODEL, D_FF), D_MODEL),
        "w_down": nrm(ks[12], (L, D_FF, D_MODEL), D_FF),
        "norm_mlp_post": gain(ks[13], (L, D_MODEL)),
    }


def reference(x, norm_mix_pre, w_in, b_gate, pool_w, pool_scale, w_branch_pool, w_branch_attn, w_out,
              norm_mix_post, norm_mlp_pre, w_up, w_down, norm_mlp_post):
    B, S, _ = x.shape
    h = x
    o_q = POOL_WIDTH
    o_k = o_q + ATTN_WIDTH
    o_v = o_k + ATTN_WIDTH
    o_g = o_v + ATTN_WIDTH
    for l in range(DEPTH):
        u = rmsnorm(h, norm_mix_pre[l])
        z = u @ w_in[l]
        p = z[..., :o_q]
        q = z[..., o_q:o_k].reshape(B, S, N_HEADS, HEAD_DIM)
        k = z[..., o_k:o_v].reshape(B, S, N_HEADS, HEAD_DIM)
        v = z[..., o_v:o_g].reshape(B, S, N_HEADS, HEAD_DIM)
        g = z[..., o_g:] + b_gate[l]
        g_pool, g_attn = g[..., :D_MODEL], g[..., D_MODEL:]
        y_pool = pool_mixer(p, pool_w[l], pool_scale[l]) @ w_branch_pool[l]
        y_attn = moba_attention(q, k, v) @ w_branch_attn[l]
        m = jax.nn.sigmoid(g_pool) * y_pool + jax.nn.sigmoid(g_attn) * y_attn
        h = h + rmsnorm(m @ w_out[l], norm_mix_post[l])
        u2 = rmsnorm(h, norm_mlp_pre[l])
        a = jnp.square(jax.nn.relu(u2 @ w_up[l]))
        h = h + rmsnorm(a @ w_down[l], norm_mlp_post[l])
    return h
```

```cpp
#include <hip/hip_runtime.h>
#include <hip/hip_cooperative_groups.h>
#include <cstdio>
#include <cstdint>
namespace cg = cooperative_groups;

#ifndef MK_N_LAUNCHES
#define MK_N_LAUNCHES 1
#endif

constexpr int BATCH = 16, SEQ = 2048, DM = 1024, M = BATCH * SEQ, NIN = 4096, FF = 4096, NH = 8, HD = 64, AW = 512, PW = 512;
constexpr int NMAIN = 3584;
constexpr float RMS_EPS = 1e-6f;
constexpr float LOG2E = 1.4426950408889634f;
constexpr float QSCALE = 0.125f * LOG2E;

namespace pg8 {
#define PG8_LAS __attribute__((address_space(3)))
typedef unsigned short bf16_t;
typedef short bf16x8 __attribute__((ext_vector_type(8)));
typedef float f32x4 __attribute__((ext_vector_type(4)));
typedef unsigned u32x4 __attribute__((ext_vector_type(4)));
constexpr int BM = 256, BK = 64, HALF = 128, HTB = HALF * BK * 2, STAGE_BYTES = 8 * HTB, NXCD = 8, WGM = 8;

__host__ __device__ __forceinline__ int lds_byte(int r, int c) { const int st = (r >> 4) * 2 + (c >> 5), rr = r & 15, cc = c & 31, ob = rr * 64 + cc * 2; return st * 1024 + (ob ^ (((ob >> 9) & 1) << 5)); }
__host__ __device__ __forceinline__ void stage_rc(int b, int& R, int& C) { const int st = b / 1024, sb = b % 1024, swz = sb ^ (((sb >> 9) & 1) << 5); R = (st >> 1) * 16 + swz / 64; C = (st & 1) * 32 + (swz % 64) / 2; }
__host__ __device__ __forceinline__ int perm32(int rho) { const int n = rho >> 4, i = rho & 15; return 8 * (i >> 2) + 4 * n + (i & 3); }

struct Unit { int pm, pn, kind; };
struct Gemm { const bf16_t* A0; const bf16_t* A1; const bf16_t* Bt0; const bf16_t* Bt1; int K; };

struct StaticOrder {
    int nM, nN, nwg, G, c, kinds;
    __host__ __device__ void init(int Mr, int Nc, int G_, int c_, int kinds_ = 1) { nM = Mr / BM; nN = Nc / BM; nwg = nM * nN; G = G_; c = c_; kinds = kinds_; }
    __host__ __device__ bool next(int i, Unit& u) const {
        const int it = i / kinds; u.kind = i - it * kinds;
        const long L = (long)it * G + c; if (L >= nwg) return false;
        int wgid = (int)L; { const int q = nwg / NXCD, r = nwg % NXCD, xcd = wgid % NXCD, off = wgid / NXCD; wgid = (xcd < r ? xcd * (q + 1) : r * (q + 1) + (xcd - r) * q) + off; }
        const int nig = WGM * nN, gid = wgid / nig, fm = gid * WGM, gsz = (nM - fm) < WGM ? (nM - fm) : WGM;
        u.pm = fm + ((wgid % nig) % gsz); u.pn = (wgid % nig) / gsz; return true;
    }
};

typedef float f32x2c __attribute__((ext_vector_type(2))); typedef __bf16 bf16x2c __attribute__((ext_vector_type(2)));
__device__ __forceinline__ unsigned cvt_pk_bf16(float lo, float hi) { f32x2c v = {lo, hi}; bf16x2c b = __builtin_convertvector(v, bf16x2c); return __builtin_bit_cast(unsigned, b); }
__device__ __forceinline__ float bf_lo(unsigned w) { return __uint_as_float(w << 16); }
__device__ __forceinline__ float bf_hi(unsigned w) { return __uint_as_float(w & 0xffff0000u); }


struct EpiBf16 {
    static constexpr bool PERM = true;
    bf16_t* O; int ldc;
    __device__ __forceinline__ void operator()(const f32x4 (&acc)[2][2][4][2], const Unit& u, int wr, int wc, int fr, int fq) const {
        const int row0 = u.pm * BM + wr * 64 + fr, col0 = u.pn * BM + wc * 32 + 8 * fq;
#pragma unroll
        for (int ai = 0; ai < 2; ++ai)
#pragma unroll
            for (int m = 0; m < 4; ++m) { bf16_t* rowp = O + (size_t)(row0 + ai * HALF + m * 16) * ldc + col0;
#pragma unroll
                for (int bj = 0; bj < 2; ++bj) { const f32x4 v0 = acc[ai][bj][m][0], v1 = acc[ai][bj][m][1];
                    u32x4 w; w.x = cvt_pk_bf16(v0[0], v0[1]); w.y = cvt_pk_bf16(v0[2], v0[3]); w.z = cvt_pk_bf16(v1[0], v1[1]); w.w = cvt_pk_bf16(v1[2], v1[3]);
                    *(u32x4*)(rowp + bj * HALF) = w; } }
    }
};
struct EpiRelu2 {
    static constexpr bool PERM = true;
    bf16_t* O; int ldc;
    __device__ __forceinline__ void operator()(const f32x4 (&acc)[2][2][4][2], const Unit& u, int wr, int wc, int fr, int fq) const {
        const int row0 = u.pm * BM + wr * 64 + fr, col0 = u.pn * BM + wc * 32 + 8 * fq;
#pragma unroll
        for (int ai = 0; ai < 2; ++ai)
#pragma unroll
            for (int m = 0; m < 4; ++m) { bf16_t* rowp = O + (size_t)(row0 + ai * HALF + m * 16) * ldc + col0;
#pragma unroll
                for (int bj = 0; bj < 2; ++bj) { f32x4 v0 = acc[ai][bj][m][0], v1 = acc[ai][bj][m][1];
#pragma unroll
                    for (int j = 0; j < 4; ++j) { const float a = fmaxf(v0[j], 0.f), b = fmaxf(v1[j], 0.f); v0[j] = a * a; v1[j] = b * b; }
                    u32x4 w; w.x = cvt_pk_bf16(v0[0], v0[1]); w.y = cvt_pk_bf16(v0[2], v0[3]); w.z = cvt_pk_bf16(v1[0], v1[1]); w.w = cvt_pk_bf16(v1[2], v1[3]);
                    *(u32x4*)(rowp + bj * HALF) = w; } }
    }
};
struct EpiF32 {
    static constexpr bool PERM = false;
    float* C; int ldc;
    __device__ __forceinline__ void operator()(const f32x4 (&acc)[2][2][4][2], const Unit& u, int wr, int wc, int fr, int fq) const {
        const int row0 = u.pm * BM + wr * 64 + fr, col0 = u.pn * BM + wc * 32 + 4 * fq;
#pragma unroll
        for (int ai = 0; ai < 2; ++ai)
#pragma unroll
            for (int m = 0; m < 4; ++m) { float* rowp = C + (size_t)(row0 + ai * HALF + m * 16) * ldc + col0;
#pragma unroll
                for (int bj = 0; bj < 2; ++bj)
#pragma unroll
                    for (int n = 0; n < 2; ++n) *(f32x4*)(rowp + bj * HALF + n * 16) = acc[ai][bj][m][n]; }
    }
};
struct EpiIn {
    static constexpr bool PERM = true;
    bf16_t *PQK, *GB; float* kpart; const float* bgate;
    __device__ __forceinline__ void operator()(const f32x4 (&acc)[2][2][4][2], const Unit& u, int wr, int wc, int fr, int fq) const {
        const int row0 = u.pm * BM + wr * 64 + fr, lcol = wc * 32 + 8 * fq, pn = u.pn;
        if (pn < 6) {
            bf16_t* base = PQK + (size_t)(pn >> 1) * ((size_t)16 << 20); const float sc = (pn >> 1) == 1 ? QSCALE : 1.f;
            const int col0 = (pn & 1) * BM + lcol;
#pragma unroll
            for (int ai = 0; ai < 2; ++ai)
#pragma unroll
                for (int m = 0; m < 4; ++m) { bf16_t* rowp = base + (size_t)(row0 + ai * HALF + m * 16) * 512 + col0;
#pragma unroll
                    for (int bj = 0; bj < 2; ++bj) { const f32x4 v0 = acc[ai][bj][m][0] * sc, v1 = acc[ai][bj][m][1] * sc;
                        u32x4 w; w.x = cvt_pk_bf16(v0[0], v0[1]); w.y = cvt_pk_bf16(v0[2], v0[3]); w.z = cvt_pk_bf16(v1[0], v1[1]); w.w = cvt_pk_bf16(v1[2], v1[3]);
                        *(u32x4*)(rowp + bj * HALF) = w; } }
            if (pn >= 4) {
#pragma unroll
                for (int bj = 0; bj < 2; ++bj)
#pragma unroll
                    for (int n = 0; n < 2; ++n) { f32x4 cs = (f32x4){0.f, 0.f, 0.f, 0.f};
#pragma unroll
                        for (int ai = 0; ai < 2; ++ai)
#pragma unroll
                            for (int m = 0; m < 4; ++m) cs += acc[ai][bj][m][n];
#pragma unroll
                        for (int o = 1; o < 16; o <<= 1) { cs[0] += __shfl_xor(cs[0], o); cs[1] += __shfl_xor(cs[1], o); cs[2] += __shfl_xor(cs[2], o); cs[3] += __shfl_xor(cs[3], o); }
                        if (fr == 0) *(f32x4*)(kpart + ((size_t)(u.pm * 2 + wr)) * 512 + (pn - 4) * BM + bj * HALF + lcol + 4 * n) = cs; }
            }
        } else {
            const int col0 = (pn - 6) * BM + lcol;
            f32x4 bv[2][2];
#pragma unroll
            for (int bj = 0; bj < 2; ++bj)
#pragma unroll
                for (int n = 0; n < 2; ++n) bv[bj][n] = *(const f32x4*)(bgate + col0 + bj * HALF + 4 * n);
#pragma unroll
            for (int ai = 0; ai < 2; ++ai)
#pragma unroll
                for (int m = 0; m < 4; ++m) { bf16_t* rowp = GB + (size_t)(row0 + ai * HALF + m * 16) * 2048 + col0;
#pragma unroll
                    for (int bj = 0; bj < 2; ++bj) { f32x4 v0 = acc[ai][bj][m][0] + bv[bj][0], v1 = acc[ai][bj][m][1] + bv[bj][1];
#pragma unroll
                        for (int j = 0; j < 4; ++j) { v0[j] = __builtin_amdgcn_rcpf(1.f + __builtin_amdgcn_exp2f(-LOG2E * v0[j])); v1[j] = __builtin_amdgcn_rcpf(1.f + __builtin_amdgcn_exp2f(-LOG2E * v1[j])); }
                        u32x4 w; w.x = cvt_pk_bf16(v0[0], v0[1]); w.y = cvt_pk_bf16(v0[2], v0[3]); w.z = cvt_pk_bf16(v1[0], v1[1]); w.w = cvt_pk_bf16(v1[2], v1[3]);
                        *(u32x4*)(rowp + bj * HALF) = w; } }
        }
    }
};
struct EpiBranch {
    static constexpr bool PERM = true;
    const bf16_t* GB; float* part; bf16_t* MB;
    __device__ __forceinline__ void operator()(const f32x4 (&acc)[2][2][4][2], const Unit& u, int wr, int wc, int fr, int fq) const {
        const int row0 = u.pm * BM + wr * 64 + fr, col0 = u.pn * BM + wc * 32 + 8 * fq;
        const int goff = u.kind == 0 ? 1024 : 0;
#pragma unroll
        for (int ai = 0; ai < 2; ++ai)
#pragma unroll
            for (int m = 0; m < 4; ++m) { const size_t row = (size_t)(row0 + ai * HALF + m * 16);
#pragma unroll
                for (int bj = 0; bj < 2; ++bj) { const int col = col0 + bj * HALF;
                    const u32x4 gw = *(const u32x4*)(GB + row * 2048 + goff + col);
                    f32x4 g0 = (f32x4){bf_lo(gw.x), bf_hi(gw.x), bf_lo(gw.y), bf_hi(gw.y)}, g1 = (f32x4){bf_lo(gw.z), bf_hi(gw.z), bf_lo(gw.w), bf_hi(gw.w)};
                    f32x4 v0 = acc[ai][bj][m][0] * g0, v1 = acc[ai][bj][m][1] * g1;
                    float* pp = part + row * DM + col;
                    if (u.kind == 0) { *(f32x4*)pp = v0; *(f32x4*)(pp + 4) = v1; }
                    else { v0 += *(const f32x4*)pp; v1 += *(const f32x4*)(pp + 4);
                        u32x4 w; w.x = cvt_pk_bf16(v0[0], v0[1]); w.y = cvt_pk_bf16(v0[2], v0[3]); w.z = cvt_pk_bf16(v1[0], v1[1]); w.w = cvt_pk_bf16(v1[2], v1[3]);
                        *(u32x4*)(MB + row * DM + col) = w; } } }
    }
};

template <class Epi, class Sched, bool ALIGN_EPI = false, bool SP2 = false>
__device__ __forceinline__ void gemm_phase(PG8_LAS unsigned char* lds, const Gemm g, const Sched& S, const Epi& E) {
    const int tid = threadIdx.x, wid = __builtin_amdgcn_readfirstlane(tid >> 6), lane = tid & 63, wr = wid >> 2, wc = wid & 3, fr = lane & 15, fq = lane >> 4;
    const int K = g.K, nt = K / BK;
    unsigned voffA[2], voffB[2];
#pragma unroll
    for (int i = 0; i < 2; ++i) { int R, C; stage_rc(tid * 16 + i * 8192, R, C); const int Rb = Epi::PERM ? ((R & ~31) + perm32(R & 31)) : R;
        voffA[i] = (unsigned)(R * K + C) * 2u; voffB[i] = (unsigned)(Rb * K + C) * 2u; }
    const size_t kstep = (size_t)(BK * 2);
    const size_t hstep = (size_t)HALF * K * 2;
    const size_t tstep = 2 * hstep;
    const unsigned ldsw = (unsigned)wid * 1024u;
    const int aoff = lds_byte(wr * 64 + fr, fq * 8), boff = lds_byte(wc * 32 + fr, fq * 8);
#define PG8_SA(b, h) (((b) * 2 + (h)) * HTB)
#define PG8_SB(b, h) ((4 + (b) * 2 + (h)) * HTB)
#define PG8_STAGE(bufoff, gbase, voff) do { _Pragma("unroll") for (int _i = 0; _i < 2; ++_i) \
        __builtin_amdgcn_global_load_lds((const unsigned*)((const char*)(gbase) + (voff)[_i]), (PG8_LAS unsigned*)(lds + (bufoff) + ldsw + _i * 8192), 16, 0, 0); } while (0)
#define PG8_LDA(dst, b, h) do { _Pragma("unroll") for (int m = 0; m < 4; ++m) _Pragma("unroll") for (int k = 0; k < 2; ++k) dst[m][k] = *(const PG8_LAS bf16x8*)(lds + PG8_SA(b, h) + aoff + m * 2048 + k * 1024); } while (0)
#define PG8_LDB(dst, b, h) do { _Pragma("unroll") for (int n = 0; n < 2; ++n) _Pragma("unroll") for (int k = 0; k < 2; ++k) dst[n][k] = *(const PG8_LAS bf16x8*)(lds + PG8_SB(b, h) + boff + n * 2048 + k * 1024); } while (0)
#define PG8_MMA(ai, bj, At, Bt) do { __builtin_amdgcn_s_setprio(1); _Pragma("unroll") for (int m = 0; m < 4; ++m) _Pragma("unroll") for (int n = 0; n < 2; ++n) _Pragma("unroll") for (int k = 0; k < 2; ++k) \
        acc[ai][bj][m][n] = __builtin_amdgcn_mfma_f32_16x16x32_bf16(Bt[n][k], At[m][k], acc[ai][bj][m][n], 0, 0, 0); __builtin_amdgcn_s_setprio(0); } while (0)
#define PG8_WAIT_V(n) asm volatile("s_waitcnt vmcnt(" #n ")" ::: "memory")
#define PG8_WAIT_L(n) asm volatile("s_waitcnt lgkmcnt(" #n ")" ::: "memory")
#define PG8_BAR __builtin_amdgcn_s_barrier()
#define PG8_SCHED __builtin_amdgcn_sched_barrier(0)
    Unit cur, nxt; int ui = 0;
    if (!S.next(0, cur)) return;
    f32x4 acc[2][2][4][2];
#pragma unroll
    for (int a = 0; a < 2; ++a)
#pragma unroll
        for (int b = 0; b < 2; ++b)
#pragma unroll
            for (int m = 0; m < 4; ++m)
#pragma unroll
                for (int n = 0; n < 2; ++n) acc[a][b][m][n] = (f32x4){0.f, 0.f, 0.f, 0.f};
    bf16x8 At[4][2], B0[2][2], B1[2][2];
    const char* cA = (const char*)(cur.kind ? g.A1 : g.A0) + (size_t)cur.pm * tstep; const char* cB = (const char*)(cur.kind ? g.Bt1 : g.Bt0) + (size_t)cur.pn * tstep;
    if constexpr (SP2) {
        PG8_STAGE(PG8_SB(0, 0), cB, voffB); PG8_STAGE(PG8_SB(0, 1), cB + hstep, voffB); PG8_STAGE(PG8_SA(0, 0), cA, voffA); PG8_STAGE(PG8_SA(0, 1), cA + hstep, voffA);
        if (wr == 1) PG8_BAR;
        PG8_WAIT_V(2); PG8_BAR;
        PG8_STAGE(PG8_SB(1, 0), cB + kstep, voffB); PG8_STAGE(PG8_SA(1, 0), cA + kstep, voffA); PG8_STAGE(PG8_SB(1, 1), cB + hstep + kstep, voffB);
        PG8_WAIT_V(6); PG8_BAR;
    } else {
        PG8_STAGE(PG8_SB(0, 0), cB, voffB); PG8_STAGE(PG8_SA(0, 0), cA, voffA); PG8_STAGE(PG8_SB(0, 1), cB + hstep, voffB); PG8_STAGE(PG8_SA(0, 1), cA + hstep, voffA);
        if (wr == 1) PG8_BAR;
        PG8_WAIT_V(4); PG8_BAR;
        PG8_STAGE(PG8_SB(1, 0), cB + kstep, voffB); PG8_STAGE(PG8_SA(1, 0), cA + kstep, voffA); PG8_STAGE(PG8_SB(1, 1), cB + hstep + kstep, voffB);
        PG8_WAIT_V(6); PG8_BAR;
    }
    for (;;) {
        const bool has_next = S.next(ui + 1, nxt);
        const char* nA = has_next ? (const char*)(nxt.kind ? g.A1 : g.A0) + (size_t)nxt.pm * tstep : cA; const char* nB = has_next ? (const char*)(nxt.kind ? g.Bt1 : g.Bt0) + (size_t)nxt.pn * tstep : cB;
        for (int t = 0; t < nt; t += 2) {
            const bool last = (t == nt - 2);
            const char* a1 = cA + (size_t)(t + 1) * kstep;
            const char* a2 = last ? nA : cA + (size_t)(t + 2) * kstep; const char* b2 = last ? nB : cB + (size_t)(t + 2) * kstep;
            const char* a3 = a2 + kstep; const char* b3 = b2 + kstep;
            if constexpr (SP2) {
            PG8_LDB(B0, 0, 0); PG8_LDB(B1, 0, 1); PG8_SCHED; PG8_LDA(At, 0, 0); PG8_STAGE(PG8_SA(1, 1), a1 + hstep, voffA);
            PG8_WAIT_V(8); PG8_WAIT_L(0); PG8_BAR; PG8_MMA(0, 0, At, B0); PG8_MMA(0, 1, At, B1); PG8_BAR; PG8_SCHED;
            PG8_LDA(At, 0, 1); PG8_STAGE(PG8_SB(0, 0), b2, voffB); PG8_STAGE(PG8_SB(0, 1), b2 + hstep, voffB); PG8_STAGE(PG8_SA(0, 0), a2, voffA);
            PG8_WAIT_V(8); PG8_WAIT_L(0); PG8_BAR; PG8_MMA(1, 0, At, B0); PG8_MMA(1, 1, At, B1); PG8_BAR; PG8_SCHED;
            PG8_LDB(B0, 1, 0); PG8_LDB(B1, 1, 1); PG8_SCHED; PG8_LDA(At, 1, 0); PG8_STAGE(PG8_SA(0, 1), a2 + hstep, voffA);
            PG8_WAIT_V(8); PG8_WAIT_L(0); PG8_BAR; PG8_MMA(0, 0, At, B0); PG8_MMA(0, 1, At, B1); PG8_BAR; PG8_SCHED;
            PG8_LDA(At, 1, 1); PG8_STAGE(PG8_SB(1, 0), b3, voffB); PG8_STAGE(PG8_SB(1, 1), b3 + hstep, voffB); PG8_STAGE(PG8_SA(1, 0), a3, voffA);
            PG8_WAIT_V(8); PG8_WAIT_L(0); PG8_BAR; PG8_MMA(1, 0, At, B0); PG8_MMA(1, 1, At, B1); PG8_BAR; PG8_SCHED;
            } else {
            PG8_LDB(B0, 0, 0); PG8_SCHED; PG8_LDA(At, 0, 0); PG8_STAGE(PG8_SA(1, 1), a1 + hstep, voffA);
            PG8_WAIT_L(8); PG8_BAR; PG8_WAIT_L(0); PG8_MMA(0, 0, At, B0); PG8_BAR; PG8_SCHED;
            PG8_LDB(B1, 0, 1); PG8_STAGE(PG8_SB(0, 0), b2, voffB);
            PG8_BAR; PG8_WAIT_L(0); PG8_MMA(0, 1, At, B1); PG8_BAR;
            PG8_LDA(At, 0, 1); PG8_STAGE(PG8_SA(0, 0), a2, voffA);
            PG8_BAR; PG8_WAIT_L(0); PG8_MMA(1, 0, At, B0); PG8_BAR; PG8_SCHED;
            PG8_STAGE(PG8_SB(0, 1), b2 + hstep, voffB);
            PG8_WAIT_V(6); PG8_BAR; PG8_MMA(1, 1, At, B1); PG8_BAR;
            PG8_LDB(B0, 1, 0); PG8_SCHED; PG8_LDA(At, 1, 0); PG8_STAGE(PG8_SA(0, 1), a2 + hstep, voffA);
            PG8_WAIT_L(8); PG8_BAR; PG8_WAIT_L(0); PG8_MMA(0, 0, At, B0); PG8_BAR; PG8_SCHED;
            PG8_LDB(B1, 1, 1); PG8_STAGE(PG8_SB(1, 0), b3, voffB);
            PG8_BAR; PG8_WAIT_L(0); PG8_MMA(0, 1, At, B1); PG8_BAR;
            PG8_LDA(At, 1, 1); PG8_STAGE(PG8_SA(1, 0), a3, voffA);
            PG8_BAR; PG8_WAIT_L(0); PG8_MMA(1, 0, At, B0); PG8_BAR; PG8_SCHED;
            PG8_STAGE(PG8_SB(1, 1), b3 + hstep, voffB);
            PG8_WAIT_V(6); PG8_BAR; PG8_MMA(1, 1, At, B1); PG8_BAR;
            }
        }
        if constexpr (ALIGN_EPI) { if (wr == 0) PG8_BAR; }
        E(acc, cur, wr, wc, fr, fq);
        if (!has_next) break;
#pragma unroll
        for (int a = 0; a < 2; ++a)
#pragma unroll
            for (int b = 0; b < 2; ++b)
#pragma unroll
                for (int m = 0; m < 4; ++m)
#pragma unroll
                    for (int n = 0; n < 2; ++n) acc[a][b][m][n] = (f32x4){0.f, 0.f, 0.f, 0.f};
        cur = nxt; cA = nA; cB = nB; ++ui;
        if constexpr (ALIGN_EPI) { if (wr == 1) PG8_BAR; }
    }
    PG8_WAIT_V(0);
    if constexpr (!ALIGN_EPI) { if (wr == 0) PG8_BAR; }
    PG8_BAR;
#undef PG8_SA
#undef PG8_SB
#undef PG8_STAGE
#undef PG8_LDA
#undef PG8_LDB
#undef PG8_MMA
#undef PG8_WAIT_V
#undef PG8_WAIT_L
#undef PG8_BAR
#undef PG8_SCHED
}
}

#define LAS __attribute__((address_space(3)))
typedef unsigned short bf16;
typedef unsigned v4u __attribute__((ext_vector_type(4)));
typedef unsigned v2u __attribute__((ext_vector_type(2)));
typedef float f32x4 __attribute__((ext_vector_type(4)));
typedef float f32x16 __attribute__((ext_vector_type(16)));
typedef short bf16x8 __attribute__((ext_vector_type(8)));
typedef short s16x4 __attribute__((ext_vector_type(4)));
typedef float f32x2_t __attribute__((ext_vector_type(2)));
typedef __bf16 bf16x2_t __attribute__((ext_vector_type(2)));
__device__ __forceinline__ unsigned cvtpk(float lo, float hi) { f32x2_t v = {lo, hi}; bf16x2_t b = __builtin_convertvector(v, bf16x2_t); return __builtin_bit_cast(unsigned, b); }
__device__ __forceinline__ float bflo(unsigned w) { return __uint_as_float(w << 16); }
__device__ __forceinline__ float bfhi(unsigned w) { return __uint_as_float(w & 0xffff0000u); }

constexpr size_t MiB = 1u << 20;
constexpr size_t WS_CTL = 0, CTL_ZERO_BYTES = 1 * MiB;
constexpr size_t WS_WIN = 2 * MiB, WS_WUP = 10 * MiB, WS_WDN = 18 * MiB, WS_WOUT = 26 * MiB, WS_WPOOL = 28 * MiB, WS_WBA = 29 * MiB, WS_KPART = 30 * MiB;
constexpr size_t WS_XN = 32 * MiB;
constexpr size_t WS_MB = 96 * MiB;
constexpr size_t WS_PB = 160 * MiB, WS_QB = 192 * MiB, WS_KB = 224 * MiB, WS_VT = 256 * MiB, WS_POOL = 288 * MiB, WS_OB = 320 * MiB;
constexpr size_t WS_GB = 352 * MiB;
constexpr size_t WS_AB = 160 * MiB;
constexpr size_t WS_DS = 32 * MiB;
constexpr size_t WS_END = 480 * MiB;

namespace att {
constexpr int KSTR = 144, VSTR = 136;
constexpr int LDS_KT = 0, LDS_VT = 64 * KSTR;
__device__ __forceinline__ int crow(int r, int hi) { return (r & 3) + 8 * (r >> 2) + 4 * hi; }

__device__ __forceinline__ void attn_unit(int b, int h, int qb, const bf16* QB, const bf16* KB, const bf16* VT, const float* kpart, bf16* OB, LAS unsigned char* lds) {
    const int tid = threadIdx.x, lane = tid & 63, r32 = lane & 31, hi = lane >> 5; const int wid = __builtin_amdgcn_readfirstlane(tid >> 6);
    const int q_rel = wid * 32 + r32;
    const size_t qrow = (size_t)b * SEQ + (size_t)qb * 256 + q_rel;
    const float beta = exp2f(-(float)(h + 1)) * LOG2E;
    bf16x8 qr[4];
#pragma unroll
    for (int d0 = 0; d0 < 4; ++d0) qr[d0] = *(const bf16x8*)(QB + qrow * 512 + h * 64 + d0 * 16 + hi * 8);
    unsigned sel = 0u;
    if (qb > 0) {
        float gate[7];
#pragma unroll
        for (int blk = 0; blk < 7; ++blk) {
            float s = -INFINITY;
            if (blk < qb) {
                const float* kp0 = kpart + ((size_t)(b * 8 + blk) * 2) * 512 + h * 64; const float* kp1 = kp0 + 512;
                s = 0.f;
#pragma unroll
                for (int d0 = 0; d0 < 4; ++d0) {
                    const f32x4 a0 = *(const f32x4*)(kp0 + d0 * 16 + hi * 8), a1 = *(const f32x4*)(kp0 + d0 * 16 + hi * 8 + 4);
                    const f32x4 b0 = *(const f32x4*)(kp1 + d0 * 16 + hi * 8), b1 = *(const f32x4*)(kp1 + d0 * 16 + hi * 8 + 4);
                    const v4u qw = __builtin_bit_cast(v4u, qr[d0]);
                    s += bflo(qw.x) * (a0[0] + b0[0]) + bfhi(qw.x) * (a0[1] + b0[1]) + bflo(qw.y) * (a0[2] + b0[2]) + bfhi(qw.y) * (a0[3] + b0[3]);
                    s += bflo(qw.z) * (a1[0] + b1[0]) + bfhi(qw.z) * (a1[1] + b1[1]) + bflo(qw.w) * (a1[2] + b1[2]) + bfhi(qw.w) * (a1[3] + b1[3]);
                }
                s += __shfl_xor(s, 32);
            }
            gate[blk] = s;
        }
#pragma unroll
        for (int i = 0; i < 7; ++i) { int cnt = 0;
#pragma unroll
            for (int j = 0; j < 7; ++j) cnt += (gate[j] > gate[i] || (gate[j] == gate[i] && j < i)) ? 1 : 0;
            if (i < qb && cnt < 3) sel |= 1u << i; }
    }
    const int NT = 4 * (qb + 1);
    float mrun = -INFINITY, lrun = 0.f; f32x16 o0 = {}, o1 = {};
    const int ldr = tid >> 3, ldc = tid & 7;
    const bf16* kg = KB + ((size_t)b * SEQ + ldr) * 512 + h * 64 + ldc * 8;
    const bf16* vg = VT + (size_t)(h * 64 + ldr) * M + (size_t)b * SEQ + ldc * 8;
    v4u kreg, vreg;
    { const int kv0 = qb * 256; kreg = *(const v4u*)(kg + (size_t)kv0 * 512); vreg = *(const v4u*)(vg + kv0); }
    for (int i = 0; i < NT; ++i) {
        const int blk = i < 4 ? qb : (i >> 2) - 1, kt = i & 3;
        __syncthreads();
        *(LAS v4u*)(lds + LDS_KT + ldr * KSTR + ldc * 16) = kreg;
        *(LAS v2u*)(lds + LDS_VT + ldr * VSTR + ldc * 16) = (v2u){vreg.x, vreg.y}; *(LAS v2u*)(lds + LDS_VT + ldr * VSTR + ldc * 16 + 8) = (v2u){vreg.z, vreg.w};
        __syncthreads();
        if (i + 1 < NT) { const int i2 = i + 1, blk2 = i2 < 4 ? qb : (i2 >> 2) - 1, kv0 = blk2 * 256 + (i2 & 3) * 64; kreg = *(const v4u*)(kg + (size_t)kv0 * 512); vreg = *(const v4u*)(vg + kv0); }
        const bool own = i < 4;
        if (own && kt * 64 > wid * 32 + 31) continue;
        f32x16 p0 = {}, p1 = {};
#pragma unroll
        for (int d0 = 0; d0 < 4; ++d0) {
            const bf16x8 a0 = *(const LAS bf16x8*)(lds + LDS_KT + r32 * KSTR + (d0 * 16 + hi * 8) * 2);
            const bf16x8 a1 = *(const LAS bf16x8*)(lds + LDS_KT + (r32 + 32) * KSTR + (d0 * 16 + hi * 8) * 2);
            p0 = __builtin_amdgcn_mfma_f32_32x32x16_bf16(a0, qr[d0], p0, 0, 0, 0);
            p1 = __builtin_amdgcn_mfma_f32_32x32x16_bf16(a1, qr[d0], p1, 0, 0, 0);
        }
        const float tb = beta * (float)((blk - qb) * 256 + kt * 64 + 4 * hi);
        if (own) {
#pragma unroll
            for (int r = 0; r < 16; ++r) { const int kv = kt * 64 + crow(r, hi); const float bl = beta * (float)((r & 3) + 8 * (r >> 2));
                p0[r] = kv > q_rel ? -INFINITY : p0[r] + tb + bl; p1[r] = kv + 32 > q_rel ? -INFINITY : p1[r] + tb + bl + 32.f * beta; }
        } else {
            const bool on = (sel >> blk) & 1u;
#pragma unroll
            for (int r = 0; r < 16; ++r) { const float bl = beta * (float)((r & 3) + 8 * (r >> 2));
                p0[r] = on ? p0[r] + tb + bl : -INFINITY; p1[r] = on ? p1[r] + tb + bl + 32.f * beta : -INFINITY; }
        }
        float rm = fmaxf(p0[0], p1[0]);
#pragma unroll
        for (int r = 1; r < 16; ++r) rm = fmaxf(rm, fmaxf(p0[r], p1[r]));
        rm = fmaxf(rm, __shfl_xor(rm, 32));
        const float mnew = fmaxf(mrun, rm);
        const float alpha = __builtin_amdgcn_exp2f(mrun - mnew);
        mrun = mnew;
        float ps = 0.f;
#pragma unroll
        for (int r = 0; r < 16; ++r) { p0[r] = __builtin_amdgcn_exp2f(p0[r] - mnew); p1[r] = __builtin_amdgcn_exp2f(p1[r] - mnew); ps += p0[r] + p1[r]; }
        lrun = lrun * alpha + ps;
#pragma unroll
        for (int r = 0; r < 16; ++r) { o0[r] *= alpha; o1[r] *= alpha; }
        v4u pf[2][2];
#pragma unroll
        for (int s = 0; s < 2; ++s) {
            pf[0][s] = (v4u){cvtpk(p0[8 * s + 0], p0[8 * s + 1]), cvtpk(p0[8 * s + 2], p0[8 * s + 3]), cvtpk(p0[8 * s + 4], p0[8 * s + 5]), cvtpk(p0[8 * s + 6], p0[8 * s + 7])};
            pf[1][s] = (v4u){cvtpk(p1[8 * s + 0], p1[8 * s + 1]), cvtpk(p1[8 * s + 2], p1[8 * s + 3]), cvtpk(p1[8 * s + 4], p1[8 * s + 5]), cvtpk(p1[8 * s + 6], p1[8 * s + 7])};
        }
#pragma unroll
        for (int kh = 0; kh < 2; ++kh)
#pragma unroll
            for (int s = 0; s < 2; ++s) {
                const LAS unsigned char* vp0 = lds + LDS_VT + r32 * VSTR + (kh * 32 + s * 16 + 4 * hi) * 2;
                const LAS unsigned char* vp1 = vp0 + 32 * VSTR;
                const v2u a0l = *(const LAS v2u*)vp0, a0h = *(const LAS v2u*)(vp0 + 16), a1l = *(const LAS v2u*)vp1, a1h = *(const LAS v2u*)(vp1 + 16);
                const bf16x8 va0 = __builtin_bit_cast(bf16x8, (v4u){a0l.x, a0l.y, a0h.x, a0h.y}), va1 = __builtin_bit_cast(bf16x8, (v4u){a1l.x, a1l.y, a1h.x, a1h.y});
                const bf16x8 pb = __builtin_bit_cast(bf16x8, pf[kh][s]);
                o0 = __builtin_amdgcn_mfma_f32_32x32x16_bf16(va0, pb, o0, 0, 0, 0);
                o1 = __builtin_amdgcn_mfma_f32_32x32x16_bf16(va1, pb, o1, 0, 0, 0);
            }
    }
    lrun += __shfl_xor(lrun, 32);
    const float inv = 1.0f / lrun;
    bf16* orow = OB + qrow * 512 + h * 64 + 4 * hi;
#pragma unroll
    for (int g = 0; g < 4; ++g) {
        *(v2u*)(orow + 8 * g) = (v2u){cvtpk(o0[4 * g] * inv, o0[4 * g + 1] * inv), cvtpk(o0[4 * g + 2] * inv, o0[4 * g + 3] * inv)};
        *(v2u*)(orow + 32 + 8 * g) = (v2u){cvtpk(o1[4 * g] * inv, o1[4 * g + 1] * inv), cvtpk(o1[4 * g + 2] * inv, o1[4 * g + 3] * inv)};
    }
    __syncthreads();
}
}

constexpr int NWAVES = 8;
constexpr int RING_BYTES = 131072, LDS_BYTES = 147456;
constexpr int N_PHASES = 9;

struct Args { const float* in[14]; float* out; unsigned char* ws; int ph_lo, ph_hi; };

__device__ __forceinline__ float wave_sum(float v) {
#pragma unroll
    for (int o = 1; o < 64; o <<= 1) v += __shfl_xor(v, o);
    return v;
}
__device__ __forceinline__ void transpose_item(const float* W, int K, int N, bf16* WT, int k0, int n0, int drow0, LAS float* scr, int lane) {
#pragma unroll 8
    for (int i = 0; i < 32; ++i) { const int kk = 2 * i + (lane >> 5); scr[kk * 33 + (lane & 31)] = W[(size_t)(k0 + kk) * N + n0 + (lane & 31)]; }
    asm volatile("s_waitcnt lgkmcnt(0)" ::: "memory");
    const int c = lane & 7;
#pragma unroll
    for (int j = 0; j < 4; ++j) { const int n = (lane >> 3) + 8 * j; const LAS float* s = scr + (8 * c) * 33 + n;
        v4u o; o.x = cvtpk(s[0 * 33], s[1 * 33]); o.y = cvtpk(s[2 * 33], s[3 * 33]); o.z = cvtpk(s[4 * 33], s[5 * 33]); o.w = cvtpk(s[6 * 33], s[7 * 33]);
        *(v4u*)(WT + (size_t)(drow0 + n) * K + k0 + 8 * c) = o; }
    asm volatile("s_waitcnt lgkmcnt(0)" ::: "memory");
}

__global__ void __launch_bounds__(NWAVES * 64, 2) fwd_kernel(Args args) {
    extern __shared__ __attribute__((aligned(16))) unsigned char lds_raw[];
    LAS unsigned char* lds = (LAS unsigned char*)lds_raw;
    const int tid = threadIdx.x, lane = tid & 63, wave = __builtin_amdgcn_readfirstlane(tid >> 6);
    const int G = gridDim.x, bx = blockIdx.x;
    const int vcu = (G % 8 == 0) ? (bx % 8) * (G / 8) + bx / 8 : bx;
    const int gw = vcu * NWAVES + wave, NGW = G * NWAVES;
    unsigned char* ws = args.ws;
    const float* x = args.in[0];
    const float* g_mix_pre = args.in[1]; const float* w_in = args.in[2]; const float* b_gate = args.in[3]; const float* pool_w = args.in[4]; const float* pool_scale = args.in[5];
    const float* w_bp = args.in[6]; const float* w_ba = args.in[7]; const float* w_out = args.in[8]; const float* g_mix_post = args.in[9]; const float* g_mlp_pre = args.in[10];
    const float* w_up = args.in[11]; const float* w_down = args.in[12]; const float* g_mlp_post = args.in[13];
    float* out = args.out;
    bf16* WinT = (bf16*)(ws + WS_WIN); bf16* WupT = (bf16*)(ws + WS_WUP); bf16* WdnT = (bf16*)(ws + WS_WDN); bf16* WoutT = (bf16*)(ws + WS_WOUT);
    bf16* WpoolT = (bf16*)(ws + WS_WPOOL); bf16* WbaT = (bf16*)(ws + WS_WBA); float* kpart = (float*)(ws + WS_KPART);
    bf16* XN = (bf16*)(ws + WS_XN); bf16* MB = (bf16*)(ws + WS_MB); bf16* PB = (bf16*)(ws + WS_PB); bf16* QB = (bf16*)(ws + WS_QB); bf16* KB = (bf16*)(ws + WS_KB);
    bf16* VT = (bf16*)(ws + WS_VT); bf16* POOL = (bf16*)(ws + WS_POOL); bf16* OB = (bf16*)(ws + WS_OB); bf16* GB = (bf16*)(ws + WS_GB); bf16* AB = (bf16*)(ws + WS_AB);
    float* DS = (float*)(ws + WS_DS);
    cg::grid_group grid = cg::this_grid();
    const int lo = args.ph_lo, hi = args.ph_hi;
#define IN(k) (lo <= (k) && (k) < hi)
#define SEAM(k) do { if (IN(k) && IN((k) + 1)) grid.sync(); } while (0)

    if (IN(0)) {
        LAS float* scr = (LAS float*)(lds + wave * 16384);
        constexpr int I_IN = 16 * 128, I_UP = 16 * 128, I_DN = 64 * 32, I_OUT = 16 * 32, I_BA = 8 * 32, NITEMS = I_IN + I_UP + I_DN + I_OUT + I_BA;
        for (int it = gw; it < NITEMS; it += NGW) {
            int r = it;
            if (r < I_IN) { const int kb = r / 128, nb = r % 128, n0 = nb * 32;
                const int drow = n0 < 1536 ? n0 : (n0 < 2048 ? n0 + 2048 : n0 - 512);
                transpose_item(w_in, DM, NIN, WinT, kb * 64, n0, drow, scr, lane); continue; } r -= I_IN;
            if (r < I_UP) { const int kb = r / 128, nb = r % 128; transpose_item(w_up, DM, FF, WupT, kb * 64, nb * 32, nb * 32, scr, lane); continue; } r -= I_UP;
            if (r < I_DN) { const int kb = r / 32, nb = r % 32; transpose_item(w_down, FF, DM, WdnT, kb * 64, nb * 32, nb * 32, scr, lane); continue; } r -= I_DN;
            if (r < I_OUT) { const int kb = r / 32, nb = r % 32; transpose_item(w_out, DM, DM, WoutT, kb * 64, nb * 32, nb * 32, scr, lane); continue; } r -= I_OUT;
            { const int kb = r / 32, nb = r % 32; transpose_item(w_ba, AW, DM, WbaT, kb * 64, nb * 32, nb * 32, scr, lane); }
        }
        for (int task = gw; task < 16 * 64; task += NGW) {
            const int nb = task & 15, ko = task >> 4, n = nb * 64 + lane, k0 = ko * 8, g = k0 >> 7, c0 = k0 & 127;
            float a[8];
#pragma unroll
            for (int j = 0; j < 8; ++j) a[j] = 0.f;
            const float* pw = pool_w + ((size_t)g * 128 + c0) * 128;
            for (int d = 0; d < 128; ++d) {
                const float wv = pool_scale[g * 128 + d] * w_bp[(size_t)(g * 128 + d) * DM + n];
#pragma unroll
                for (int j = 0; j < 8; ++j) a[j] += pw[j * 128 + d] * wv;
            }
            v4u o; o.x = cvtpk(a[0], a[1]); o.y = cvtpk(a[2], a[3]); o.z = cvtpk(a[4], a[5]); o.w = cvtpk(a[6], a[7]);
            *(v4u*)(WpoolT + (size_t)n * PW + k0) = o;
        }
        f32x4 gv[4];
#pragma unroll
        for (int j = 0; j < 4; ++j) gv[j] = ((const f32x4*)g_mix_pre)[lane + 64 * j];
        for (int m = gw; m < M; m += NGW) {
            const f32x4* xr = (const f32x4*)(x + (size_t)m * DM) + lane;
            f32x4 v[4]; float s = 0.f;
#pragma unroll
            for (int j = 0; j < 4; ++j) { v[j] = xr[64 * j]; s += (v[j].x * v[j].x + v[j].y * v[j].y) + (v[j].z * v[j].z + v[j].w * v[j].w); }
            const float rs = 1.0f / sqrtf(wave_sum(s) * (1.f / DM) + RMS_EPS);
            v2u* o8 = (v2u*)(XN + (size_t)m * DM) + lane;
#pragma unroll
            for (int j = 0; j < 4; ++j) { const f32x4 t = v[j] * rs * gv[j]; o8[64 * j] = (v2u){cvtpk(t.x, t.y), cvtpk(t.z, t.w)}; }
        }
    }
    SEAM(0);

    if (IN(1)) {
        { pg8::Gemm g{XN, XN, WinT, WinT, DM}; pg8::StaticOrder S; S.init(M, NMAIN, G, bx);
          pg8::EpiIn E{PB, GB, kpart, b_gate};
          pg8::gemm_phase<pg8::EpiIn, pg8::StaticOrder, true, true>(lds, g, S, E); }
        { const bf16* WvT = WinT + (size_t)NMAIN * DM; pg8::Gemm g{WvT, WvT, XN, XN, DM}; pg8::StaticOrder S; S.init(AW, M, G, bx);
          pg8::EpiBf16 E{VT, M};
          pg8::gemm_phase<pg8::EpiBf16, pg8::StaticOrder, true, true>(lds, g, S, E); }
    }
    SEAM(1);

    if (IN(2)) {
        {
            for (int task = vcu * 512 + tid; task < (M / 16) * 64; task += G * 512) {
                const int oct = task & 63, run = task >> 6, m0 = run * 16, t0 = m0 & (SEQ - 1), w = 2 << (oct >> 4);
                const bf16* pp = PB + (size_t)m0 * PW + oct * 8; bf16* po = POOL + (size_t)m0 * PW + oct * 8;
                float acc[8];
#pragma unroll
                for (int j = 0; j < 8; ++j) acc[j] = 0.f;
                for (int i = -(w - 1); i < 16; ++i) {
                    const int t = t0 + i;
                    v4u cur = (v4u){0u, 0u, 0u, 0u};
                    if (t >= 0) { cur = *(const v4u*)(pp + (ptrdiff_t)i * PW);
                        acc[0] += bflo(cur.x); acc[1] += bfhi(cur.x); acc[2] += bflo(cur.y); acc[3] += bfhi(cur.y); acc[4] += bflo(cur.z); acc[5] += bfhi(cur.z); acc[6] += bflo(cur.w); acc[7] += bfhi(cur.w); }
                    if (i >= 0) {
                        const float ic = 1.0f / (float)(t + 1 < w ? t + 1 : w);
                        v4u o; o.x = cvtpk(acc[0] * ic - bflo(cur.x), acc[1] * ic - bfhi(cur.x)); o.y = cvtpk(acc[2] * ic - bflo(cur.y), acc[3] * ic - bfhi(cur.y));
                        o.z = cvtpk(acc[4] * ic - bflo(cur.z), acc[5] * ic - bfhi(cur.z)); o.w = cvtpk(acc[6] * ic - bflo(cur.w), acc[7] * ic - bfhi(cur.w));
                        *(v4u*)(po + (size_t)i * PW) = o;
                    }
                    const int tt = t - (w - 1);
                    if (i >= 0 && tt >= 0) { const v4u old = *(const v4u*)(pp + (ptrdiff_t)(i - (w - 1)) * PW);
                        acc[0] -= bflo(old.x); acc[1] -= bfhi(old.x); acc[2] -= bflo(old.y); acc[3] -= bfhi(old.y); acc[4] -= bflo(old.z); acc[5] -= bfhi(old.z); acc[6] -= bflo(old.w); acc[7] -= bfhi(old.w); }
                }
            }
        }
        {
            const int nun = BATCH * NH * 8;
            if (G == 256) {
                const int bh = vcu >> 1, s = vcu & 1;
                for (int i = 0; i < 4; ++i) { const int qb = s == 0 ? (i == 0 ? 7 : i == 1 ? 0 : i == 2 ? 5 : 2) : (i == 0 ? 6 : i == 1 ? 1 : i == 2 ? 4 : 3);
                    att::attn_unit(bh >> 3, bh & 7, qb, QB, KB, VT, kpart, OB, lds); }
            } else {
                for (int un = vcu; un < nun; un += G) att::attn_unit(un >> 6, (un >> 3) & 7, 7 - (un & 7), QB, KB, VT, kpart, OB, lds);
            }
        }
    }
    SEAM(2);

    if (IN(3)) {
        pg8::Gemm g{OB, POOL, WbaT, WpoolT, AW}; pg8::StaticOrder S; S.init(M, DM, G, bx, 2);
        pg8::EpiBranch E{GB, out, MB};
        pg8::gemm_phase<pg8::EpiBranch, pg8::StaticOrder, true, true>(lds, g, S, E);
    }
    SEAM(3);

    if (IN(4)) {
        pg8::Gemm g{MB, MB, WoutT, WoutT, DM}; pg8::StaticOrder S; S.init(M, DM, G, bx);
        pg8::EpiF32 E{out, DM};
        pg8::gemm_phase<pg8::EpiF32, pg8::StaticOrder, true, true>(lds, g, S, E);
    }
    SEAM(4);

    if (IN(5)) {
        f32x4 g1[4], g2[4];
#pragma unroll
        for (int j = 0; j < 4; ++j) { g1[j] = ((const f32x4*)g_mix_post)[lane + 64 * j]; g2[j] = ((const f32x4*)g_mlp_pre)[lane + 64 * j]; }
        for (int m = gw; m < M; m += NGW) {
            f32x4* orow = (f32x4*)(out + (size_t)m * DM) + lane; const f32x4* xr = (const f32x4*)(x + (size_t)m * DM) + lane;
            f32x4 v[4], xv[4]; float s = 0.f;
#pragma unroll
            for (int j = 0; j < 4; ++j) { v[j] = orow[64 * j]; xv[j] = xr[64 * j]; s += (v[j].x * v[j].x + v[j].y * v[j].y) + (v[j].z * v[j].z + v[j].w * v[j].w); }
            const float rs = 1.0f / sqrtf(wave_sum(s) * (1.f / DM) + RMS_EPS);
            float s2 = 0.f;
#pragma unroll
            for (int j = 0; j < 4; ++j) { v[j] = xv[j] + v[j] * rs * g1[j]; s2 += (v[j].x * v[j].x + v[j].y * v[j].y) + (v[j].z * v[j].z + v[j].w * v[j].w); orow[64 * j] = v[j]; }
            const float rs2 = 1.0f / sqrtf(wave_sum(s2) * (1.f / DM) + RMS_EPS);
            v2u* o8 = (v2u*)(XN + (size_t)m * DM) + lane;
#pragma unroll
            for (int j = 0; j < 4; ++j) { const f32x4 t = v[j] * rs2 * g2[j]; o8[64 * j] = (v2u){cvtpk(t.x, t.y), cvtpk(t.z, t.w)}; }
        }
    }
    SEAM(5);

    if (IN(6)) {
        pg8::Gemm g{XN, XN, WupT, WupT, DM}; pg8::StaticOrder S; S.init(M, FF, G, bx);
        pg8::EpiRelu2 E{AB, FF};
        pg8::gemm_phase<pg8::EpiRelu2, pg8::StaticOrder, true, true>(lds, g, S, E);
    }
    SEAM(6);

    if (IN(7)) {
        pg8::Gemm g{AB, AB, WdnT, WdnT, FF}; pg8::StaticOrder S; S.init(M, DM, G, bx);
        pg8::EpiF32 E{DS, DM};
        pg8::gemm_phase<pg8::EpiF32, pg8::StaticOrder, true, true>(lds, g, S, E);
    }
    SEAM(7);

    if (IN(8)) {
        f32x4 g1[4];
#pragma unroll
        for (int j = 0; j < 4; ++j) g1[j] = ((const f32x4*)g_mlp_post)[lane + 64 * j];
        for (int m = gw; m < M; m += NGW) {
            f32x4* orow = (f32x4*)(out + (size_t)m * DM) + lane; const f32x4* dr = (const f32x4*)(DS + (size_t)m * DM) + lane;
            f32x4 v[4], hv[4]; float s = 0.f;
#pragma unroll
            for (int j = 0; j < 4; ++j) { v[j] = dr[64 * j]; hv[j] = orow[64 * j]; s += (v[j].x * v[j].x + v[j].y * v[j].y) + (v[j].z * v[j].z + v[j].w * v[j].w); }
            const float rs = 1.0f / sqrtf(wave_sum(s) * (1.f / DM) + RMS_EPS);
#pragma unroll
            for (int j = 0; j < 4; ++j) orow[64 * j] = hv[j] + v[j] * rs * g1[j];
        }
    }
#undef IN
#undef SEAM
}

extern "C" void kernel_launch(void* const* d_in, const int* in_sizes, int n_in, void* d_out, int out_size, void* d_ws, size_t ws_size, hipStream_t stream) {
    static int grid = 0;
    if (grid == 0) {
        if (n_in != 14 || in_sizes[0] != M * DM || out_size != M * DM || ws_size < WS_END) {
            fprintf(stderr, "kernel_launch: unexpected shapes (n_in %d, in0 %d, out %d, ws %zu); nothing launched\n", n_in, n_in > 0 ? in_sizes[0] : -1, out_size, ws_size); grid = -1; return; }
        int dev = 0, cus = 0, per_cu = 0;
        if (hipGetDevice(&dev) != hipSuccess || hipDeviceGetAttribute(&cus, hipDeviceAttributeMultiprocessorCount, dev) != hipSuccess) { grid = -1; return; }
        if (hipFuncSetAttribute((const void*)fwd_kernel, hipFuncAttributeMaxDynamicSharedMemorySize, LDS_BYTES) != hipSuccess) { fprintf(stderr, "kernel_launch: hipFuncSetAttribute failed\n"); grid = -1; return; }
        if (hipOccupancyMaxActiveBlocksPerMultiprocessor(&per_cu, (const void*)fwd_kernel, NWAVES * 64, LDS_BYTES) != hipSuccess || per_cu < 1) {
            fprintf(stderr, "kernel_launch: occupancy query says %d blocks per CU\n", per_cu); (void)hipGetLastError(); per_cu = 1; }
        grid = cus;
    }
    if (grid < 0) return;
    Args a{};
    for (int i = 0; i < 14; ++i) a.in[i] = (const float*)d_in[i];
    a.out = (float*)d_out; a.ws = (unsigned char*)d_ws;
#if MK_N_LAUNCHES == 1
    a.ph_lo = 0; a.ph_hi = N_PHASES;
    void* kargs[] = {&a};
    hipError_t e = hipLaunchCooperativeKernel((const void*)fwd_kernel, dim3(grid), dim3(NWAVES * 64), kargs, LDS_BYTES, stream);
    if (e != hipSuccess) fprintf(stderr, "kernel_launch: cooperative launch failed: %s (grid %d)\n", hipGetErrorString(e), grid);
#else
    for (int p = 0; p < N_PHASES; ++p) {
        a.ph_lo = p; a.ph_hi = p + 1;
        hipLaunchKernelGGL(fwd_kernel, dim3(grid), dim3(NWAVES * 64), LDS_BYTES, stream, a);
    }
#endif
}
```
